# Optimizing an MI355X kernel written in HIP

```python
import jax, jax.numpy as jnp
from jax import lax
import numpy as np


D_MODEL = 1024
BATCH = 4
SEQ = 8192
DEPTH = 1

CHUNK = 64
Q_BLOCK = 128
SB_HEADS = 8
SB_HEAD_DIM = 64
SB_WIDTH = SB_HEADS * SB_HEAD_DIM
CONV_WIDTH = D_MODEL // 2
CONV_K = 3
N_GROUPS = 4
EXPERTS_PER_GROUP = 8
N_EXPERTS = N_GROUPS * EXPERTS_PER_GROUP
TOP_K = 2
D_EXPERT = D_MODEL // 2
EXPERT_BLOCK = 128
PROJ_WIDTH = 3 * SB_WIDTH + 3 * CONV_WIDTH + 2 * D_MODEL
DEEPNORM_ALPHA = (2.0 * DEPTH) ** 0.25
DEEPNORM_BETA = (8.0 * DEPTH) ** -0.25
LN_EPS = 1e-5

kernel_name = 'hybrid_stickbreak_shortconv_hmoe'


def layer_norm(x, g, b):
    xf = x.astype(jnp.float32)
    mu = jnp.mean(xf, axis=-1, keepdims=True)
    var = jnp.mean(jnp.square(xf - mu), axis=-1, keepdims=True)
    return ((xf - mu) * lax.rsqrt(var + LN_EPS) * g + b).astype(x.dtype)


def stick_breaking_attention(q, k, v):
    bsz, h, s, dh = q.shape
    nq = s // Q_BLOCK
    scale = dh ** -0.5
    q_blocks = q.reshape(bsz, h, nq, Q_BLOCK, dh).transpose(2, 0, 1, 3, 4)
    kf = k.astype(jnp.float32)
    vf = v.astype(jnp.float32)
    k_pos = jnp.arange(s)

    def one_block(args):
        qb, blk = args
        z = jnp.einsum('bhqd,bhkd->bhqk', qb.astype(jnp.float32), kf) * scale
        q_pos = blk * Q_BLOCK + jnp.arange(Q_BLOCK)
        mask = k_pos[None, :] < q_pos[:, None]
        log_stay = jnp.where(mask, jax.nn.log_sigmoid(-z), 0.0)
        tail = lax.cumsum(log_stay, axis=3, reverse=True)
        tail = jnp.concatenate([tail[..., 1:], jnp.zeros_like(tail[..., :1])], axis=-1)
        weights = jnp.where(mask, jnp.exp(jax.nn.log_sigmoid(z) + tail), 0.0)
        return jnp.einsum('bhqk,bhkd->bhqd', weights, vf)

    out = lax.map(one_block, (q_blocks, jnp.arange(nq)))
    return out.transpose(1, 2, 0, 3, 4).reshape(bsz, h, s, dh).astype(q.dtype)


def short_gated_conv(cb, cc, ch, conv_w):
    u = cc * ch
    s = u.shape[1]
    u_pad = jnp.pad(u, ((0, 0), (CONV_K - 1, 0), (0, 0)))
    y = sum(conv_w[i] * u_pad[:, i:i + s] for i in range(CONV_K))
    return cb * y


def token_mixer(x, w_in, gate_bias, conv_w, w_branch_a, w_branch_b, w_out):
    bsz, s, _ = x.shape
    proj = x @ w_in
    splits = [SB_WIDTH, 2 * SB_WIDTH, 3 * SB_WIDTH,
              3 * SB_WIDTH + CONV_WIDTH, 3 * SB_WIDTH + 2 * CONV_WIDTH,
              3 * SB_WIDTH + 3 * CONV_WIDTH]
    q, k, v, cb, cc, ch, gate_logits = jnp.split(proj, splits, axis=-1)

    def heads(t):
        return t.reshape(bsz, s, SB_HEADS, SB_HEAD_DIM).transpose(0, 2, 1, 3)

    attn = stick_breaking_attention(heads(q), heads(k), heads(v))
    attn = attn.transpose(0, 2, 1, 3).reshape(bsz, s, SB_WIDTH)
    branch_a = attn @ w_branch_a
    branch_b = short_gated_conv(cb, cc, ch, conv_w) @ w_branch_b
    gates = jax.nn.sigmoid((gate_logits + gate_bias).astype(jnp.float32)).astype(x.dtype)
    gate_a, gate_b = jnp.split(gates, 2, axis=-1)
    return (gate_a * branch_a + gate_b * branch_b) @ w_out


def hierarchical_moe(x, w_router_g, b_router_g, w_router_e, b_router_e, w_gate, w_up, w_down):
    bsz, s, d = x.shape
    t = bsz * s
    xt = x.reshape(t, d)
    group_logits = (xt @ w_router_g).astype(jnp.float32) + b_router_g
    group_prob, group_idx = lax.top_k(jax.nn.softmax(group_logits, axis=-1), 1)
    expert_logits = (xt @ w_router_e).astype(jnp.float32).reshape(t, N_GROUPS, EXPERTS_PER_GROUP) + b_router_e
    in_group = jnp.take_along_axis(expert_logits, group_idx[:, :, None], axis=1)[:, 0]
    exp_prob, exp_idx = lax.top_k(jax.nn.softmax(in_group, axis=-1), TOP_K)
    exp_prob = exp_prob / jnp.sum(exp_prob, axis=-1, keepdims=True)
    route_w = (group_prob * exp_prob).reshape(-1)
    route_e = (group_idx * EXPERTS_PER_GROUP + exp_idx).reshape(-1)
    route_tok = jnp.repeat(jnp.arange(t, dtype=jnp.int32), TOP_K)
    n = t * TOP_K
    order = jnp.argsort(route_e)
    e_s = route_e[order]
    tok_s = route_tok[order]
    w_s = route_w[order]
    counts = jnp.bincount(route_e, length=N_EXPERTS)
    start = jnp.cumsum(counts) - counts
    padded = (counts + EXPERT_BLOCK - 1) // EXPERT_BLOCK * EXPERT_BLOCK
    pad_end = jnp.cumsum(padded)
    dest = pad_end[e_s] - padded[e_s] + jnp.arange(n, dtype=jnp.int32) - start[e_s]
    n_blocks = -(-n // EXPERT_BLOCK) + N_EXPERTS
    slot_tok = jnp.full((n_blocks * EXPERT_BLOCK,), t, jnp.int32).at[dest].set(tok_s)
    block_expert = jnp.minimum(
        jnp.searchsorted(pad_end, jnp.arange(n_blocks) * EXPERT_BLOCK, side='right'), N_EXPERTS - 1)
    x_pad = jnp.concatenate([xt, jnp.zeros((1, d), xt.dtype)], axis=0)
    x_blocks = x_pad[slot_tok].reshape(n_blocks, EXPERT_BLOCK, d)

    def expert_block(args):
        xb, e = args
        hidden = jax.nn.silu(xb @ w_gate[e]) * (xb @ w_up[e])
        return hidden @ w_down[e]

    y_slots = lax.map(expert_block, (x_blocks, block_expert)).reshape(-1, d)
    y_assign = y_slots[dest] * w_s[:, None].astype(x.dtype)
    y = jax.ops.segment_sum(y_assign, tok_s, num_segments=t)
    return y.reshape(bsz, s, d)


def setup_inputs(seed: int = 0) -> dict:
    key = jax.random.key(seed)
    ks = jax.random.split(key, 18)
    L, D = DEPTH, D_MODEL
    beta = DEEPNORM_BETA

    def nrm(k, shape, scale):
        return jax.random.normal(k, shape, jnp.float32) * scale

    col_scale = jnp.concatenate([
        jnp.ones((2 * SB_WIDTH,), jnp.float32), jnp.full((SB_WIDTH,), beta, jnp.float32),
        jnp.ones((2 * CONV_WIDTH,), jnp.float32), jnp.full((CONV_WIDTH,), beta, jnp.float32),
        jnp.ones((2 * D,), jnp.float32)])
    return {
        'x': nrm(ks[0], (BATCH, SEQ, D), 1.0),
        'w_in': nrm(ks[1], (L, D, PROJ_WIDTH), D ** -0.5) * col_scale,
        'gate_bias': nrm(ks[2], (L, 2 * D), 0.02),
        'conv_w': nrm(ks[3], (L, CONV_K, CONV_WIDTH), CONV_K ** -0.5),
        'w_branch_a': nrm(ks[4], (L, SB_WIDTH, D), SB_WIDTH ** -0.5 * beta),
        'w_branch_b': nrm(ks[5], (L, CONV_WIDTH, D), CONV_WIDTH ** -0.5 * beta),
        'w_out': nrm(ks[6], (L, D, D), D ** -0.5 * beta),
        'ln1_g': 1.0 + nrm(ks[7], (L, D), 0.02),
        'ln1_b': nrm(ks[8], (L, D), 0.02),
        'w_router_g': nrm(ks[9], (L, D, N_GROUPS), D ** -0.5),
        'b_router_g': nrm(ks[10], (L, N_GROUPS), 0.01),
        'w_router_e': nrm(ks[11], (L, D, N_EXPERTS), D ** -0.5),
        'b_router_e': nrm(ks[12], (L, N_GROUPS, EXPERTS_PER_GROUP), 0.01),
        'w_gate': nrm(ks[13], (L, N_EXPERTS, D, D_EXPERT), D ** -0.5 * beta),
        'w_up': nrm(ks[14], (L, N_EXPERTS, D, D_EXPERT), D ** -0.5 * beta),
        'w_down': nrm(ks[15], (L, N_EXPERTS, D_EXPERT, D), D_EXPERT ** -0.5 * beta),
        'ln2_g': 1.0 + nrm(ks[16], (L, D), 0.02),
        'ln2_b': nrm(ks[17], (L, D), 0.02),
    }


def reference(x, w_in, gate_bias, conv_w, w_branch_a, w_branch_b, w_out, ln1_g, ln1_b,
              w_router_g, b_router_g, w_router_e, b_router_e, w_gate, w_up, w_down,
              ln2_g, ln2_b):
    h = x
    for l in range(DEPTH):
        mixed = token_mixer(h, w_in[l], gate_bias[l], conv_w[l], w_branch_a[l], w_branch_b[l], w_out[l])
        h = layer_norm(DEEPNORM_ALPHA * h + mixed, ln1_g[l], ln1_b[l])
        ffn = hierarchical_moe(h, w_router_g[l], b_router_g[l], w_router_e[l], b_router_e[l],
                               w_gate[l], w_up[l], w_down[l])
        h = layer_norm(DEEPNORM_ALPHA * h + ffn, ln2_g[l], ln2_b[l])
    return h
```

```cpp
#include <hip/hip_runtime.h>
#include <cstdio>
#include <cstdint>

#ifndef MK_N_LAUNCHES
#define MK_N_LAUNCHES 9
#endif

#define LAS __attribute__((address_space(3)))
typedef unsigned short bf16_t;
typedef short bf16x8 __attribute__((ext_vector_type(8)));
typedef short s16x4 __attribute__((ext_vector_type(4)));
typedef float f32x2 __attribute__((ext_vector_type(2)));
typedef float f32x4 __attribute__((ext_vector_type(4)));
typedef float f32x16 __attribute__((ext_vector_type(16)));
typedef unsigned u32x2 __attribute__((ext_vector_type(2)));
typedef unsigned u32x4 __attribute__((ext_vector_type(4)));
typedef __bf16 bf16x2_t __attribute__((ext_vector_type(2)));

constexpr int BATCH = 4, SEQ = 8192, D = 1024, T = BATCH * SEQ;
constexpr int NHEAD = 8, HD = 64, SBW = 512, CW = 512, PROJ = 5120;
constexpr int NEXP = 32, NGRP = 4, EPG = 8, DEXP = 512;
constexpr float LN_EPS = 1e-5f;
constexpr float ALPHA = 1.189207115002721f;
constexpr float LOG2E = 1.4426950408889634f;
constexpr float QSCALE = 0.125f * LOG2E;
constexpr float R_STOP = 152.0f;
constexpr int MAX_TILES = 2 * T / 256 + NEXP;

constexpr size_t MiB = 1u << 20;
constexpr size_t WS_CTL = 0, CTL_ZERO_BYTES = 64 * 1024;
constexpr size_t WS_RTAB = 1 * MiB;
constexpr size_t WS_WIN = 2 * MiB;
constexpr size_t WS_WAB = 12 * MiB;
constexpr size_t WS_WOUT = 14 * MiB;
constexpr size_t WS_WGU = 16 * MiB;
constexpr size_t WS_WD = 80 * MiB;
constexpr size_t WS_RA = 112 * MiB;
constexpr size_t WS_P6 = 176 * MiB;
constexpr size_t WS_R = 368 * MiB;
constexpr size_t WS_GB = 432 * MiB;
constexpr size_t WS_MERGED = 176 * MiB;
constexpr size_t WS_H = 240 * MiB;
constexpr size_t WS_Y = 312 * MiB;
constexpr size_t WS_SLOT = 496 * MiB;
constexpr size_t WS_RT = 500 * MiB;
constexpr size_t WS_END = 501 * MiB;
static_assert(WS_H + (size_t)MAX_TILES * 256 * 512 * 2 <= WS_Y && WS_Y + (size_t)MAX_TILES * 256 * 1024 * 2 <= WS_SLOT, "ws map");
constexpr int CW_CNT = 64;
constexpr int CW_BAR = 4096;

constexpr int RING_BYTES = 131072;
constexpr int RTAB_BYTES = 36 * 1024 * 4;
constexpr int MISC_OFF = RTAB_BYTES;
constexpr int LDS_BYTES = MISC_OFF + 4096;

__device__ __forceinline__ unsigned cvtpk(float lo, float hi) { f32x2 v = {lo, hi}; bf16x2_t b = __builtin_convertvector(v, bf16x2_t); return __builtin_bit_cast(unsigned, b); }
__device__ __forceinline__ float bflo(unsigned w) { return __uint_as_float(w << 16); }
__device__ __forceinline__ float bfhi(unsigned w) { return __uint_as_float(w & 0xffff0000u); }
__device__ __forceinline__ float wave_sum(float v) {
#pragma unroll
    for (int o = 1; o < 64; o <<= 1) v += __shfl_xor(v, o);
    return v;
}
__device__ __forceinline__ float wave_sum_u(float x) {
    x += __builtin_bit_cast(float, __builtin_amdgcn_update_dpp(0, __builtin_bit_cast(int, x), 0xB1, 0xF, 0xF, true));
    x += __builtin_bit_cast(float, __builtin_amdgcn_update_dpp(0, __builtin_bit_cast(int, x), 0x4E, 0xF, 0xF, true));
    x += __builtin_bit_cast(float, __builtin_amdgcn_update_dpp(0, __builtin_bit_cast(int, x), 0x141, 0xF, 0xF, true));
    x += __builtin_bit_cast(float, __builtin_amdgcn_update_dpp(0, __builtin_bit_cast(int, x), 0x140, 0xF, 0xF, true));
    const int xi = __builtin_bit_cast(int, x);
    const float a = __builtin_bit_cast(float, __builtin_amdgcn_readlane(xi, 0)), b = __builtin_bit_cast(float, __builtin_amdgcn_readlane(xi, 16));
    const float c = __builtin_bit_cast(float, __builtin_amdgcn_readlane(xi, 32)), d = __builtin_bit_cast(float, __builtin_amdgcn_readlane(xi, 48));
    return (a + b) + (c + d);
}

namespace pg8 {
constexpr int BM = 256, BK = 64, HALF = 128, HTB = HALF * BK * 2, STAGE_BYTES = 8 * HTB, NXCD = 8, WGM = 8;
__host__ __device__ __forceinline__ int lds_byte(int r, int c) { const int st = (r >> 4) * 2 + (c >> 5), rr = r & 15, cc = c & 31, ob = rr * 64 + cc * 2; return st * 1024 + (ob ^ (((ob >> 9) & 1) << 5)); }
__host__ __device__ __forceinline__ void stage_rc(int b, int& R, int& C) { const int st = b / 1024, sb = b % 1024, swz = sb ^ (((sb >> 9) & 1) << 5); R = (st >> 1) * 16 + swz / 64; C = (st & 1) * 32 + (swz % 64) / 2; }
__host__ __device__ __forceinline__ int perm32(int rho) { const int n = rho >> 4, i = rho & 15; return 8 * (i >> 2) + 4 * n + (i & 3); }

struct Unit { int pm, pn, e; };

struct DenseOrder {
    const char* A; const char* Bt; int K; int nM, nN, nwg, G, c;
    __device__ void init(const void* A_, const void* Bt_, int M, int N, int K_, int G_, int c_) { A = (const char*)A_; Bt = (const char*)Bt_; K = K_; nM = M / BM; nN = N / BM; nwg = nM * nN; G = G_; c = c_; }
    __device__ __forceinline__ bool next(int i, Unit& u) const {
        const long L = (long)i * G + c; if (L >= nwg) return false;
        int wgid = (int)L; { const int q = nwg / NXCD, r = nwg % NXCD, xcd = wgid % NXCD, off = wgid / NXCD; wgid = (xcd < r ? xcd * (q + 1) : r * (q + 1) + (xcd - r) * q) + off; }
        const int nig = WGM * nN, gid = wgid / nig, fm = gid * WGM, gsz = (nM - fm) < WGM ? (nM - fm) : WGM;
        u.pm = fm + ((wgid % nig) % gsz); u.pn = (wgid % nig) / gsz; u.e = 0; return true;
    }
    __device__ __forceinline__ const char* a_base(const Unit& u) const { return A + (size_t)u.pm * BM * K * 2; }
    __device__ __forceinline__ const char* b_base(const Unit& u) const { return Bt + (size_t)u.pn * BM * K * 2; }
    __device__ __forceinline__ unsigned a_row(const Unit&, int) const { return 0u; }
};
struct MoeOrder {
    const char* A; const char* Bt; int K; size_t bstride; int G, vcu; bool gather;
    const LAS int* tb; const LAS int* cnt; const int* slot_tok;
    __device__ __forceinline__ bool next(int i, Unit& u) const {
        const int L = i * G + vcu; if (L >= 4 * tb[NEXP]) return false;
        const int gt = L >> 2; int e = 0;
        while (tb[e + 1] <= gt) ++e;
        u.pm = gt; u.pn = L & 3; u.e = e; return true;
    }
    __device__ __forceinline__ const char* a_base(const Unit& u) const { return gather ? A : A + (size_t)u.pm * BM * K * 2; }
    __device__ __forceinline__ const char* b_base(const Unit& u) const { return Bt + (size_t)u.e * bstride + (size_t)u.pn * BM * K * 2; }
    __device__ __forceinline__ unsigned a_row(const Unit& u, int r) const { const int rank = (u.pm - tb[u.e]) * BM + r; return rank < cnt[u.e] ? (unsigned)slot_tok[(size_t)u.e * T + rank] : 0u; }
};

__device__ __forceinline__ u32x4 pack8(const f32x4 a, const f32x4 b) { u32x4 w; w.x = cvtpk(a[0], a[1]); w.y = cvtpk(a[2], a[3]); w.z = cvtpk(b[0], b[1]); w.w = cvtpk(b[2], b[3]); return w; }

struct EpiProj {
    static constexpr bool HAS_MID = false;
    bf16_t* P6; bf16_t* Rb; bf16_t* Gb; const float* gate_bias;
    __device__ __forceinline__ void mid(f32x4 (&)[2][2][4][2], const Unit&, int, int, int, int) const {}
    __device__ __forceinline__ void operator()(const f32x4 (&acc)[2][2][4][2], const Unit& u, int wr, int wc, int fr, int fq) const {
        const int row0 = u.pm * BM + wr * 64 + fr;
        if (u.pn < 12) {
            const int t = u.pn >> 1; bf16_t* base = P6 + (size_t)t * T * 512; const float sc = (t == 0) ? QSCALE : 1.0f;
            const int col0 = (u.pn & 1) * 256 + wc * 32 + 8 * fq;
#pragma unroll
            for (int ai = 0; ai < 2; ++ai)
#pragma unroll
                for (int m = 0; m < 4; ++m) { bf16_t* rowp = base + (size_t)(row0 + ai * HALF + m * 16) * 512 + col0;
#pragma unroll
                    for (int bj = 0; bj < 2; ++bj) *(u32x4*)(rowp + bj * HALF) = pack8(acc[ai][bj][m][0] * sc, acc[ai][bj][m][1] * sc); }
        } else {
            const int col0 = (u.pn - 12) * 128 + wc * 32 + 8 * fq;
            f32x4 ba[2], bb[2];
#pragma unroll
            for (int n = 0; n < 2; ++n) { ba[n] = *(const f32x4*)(gate_bias + col0 + 4 * n); bb[n] = *(const f32x4*)(gate_bias + 1024 + col0 + 4 * n); }
#pragma unroll
            for (int ai = 0; ai < 2; ++ai)
#pragma unroll
                for (int m = 0; m < 4; ++m) { const size_t off = (size_t)(row0 + ai * HALF + m * 16) * 1024 + col0; f32x4 rv[2], gv[2];
#pragma unroll
                    for (int n = 0; n < 2; ++n)
#pragma unroll
                        for (int j = 0; j < 4; ++j) {
                            float za = acc[ai][0][m][n][j] + ba[n][j], zb = acc[ai][1][m][n][j] + bb[n][j];
                            za = fminf(fmaxf(za, -30.f), 30.f); zb = fminf(fmaxf(zb, -30.f), 30.f);
                            const float ea = __builtin_amdgcn_exp2f(-LOG2E * za), eb = __builtin_amdgcn_exp2f(-LOG2E * zb);
                            gv[n][j] = __builtin_amdgcn_rcpf(1.0f + eb); rv[n][j] = (1.0f + eb) * __builtin_amdgcn_rcpf(1.0f + ea); }
                    *(u32x4*)(Rb + off) = pack8(rv[0], rv[1]); *(u32x4*)(Gb + off) = pack8(gv[0], gv[1]); }
        }
    }
};
struct EpiMerged {
    static constexpr bool HAS_MID = true;
    const bf16_t* Rb; const bf16_t* Gb; bf16_t* O;
    __device__ __forceinline__ void mid(f32x4 (&acc)[2][2][4][2], const Unit& u, int wr, int wc, int fr, int fq) const {
        asm volatile("" : "+v"(fr), "+v"(fq));
        const int row0 = u.pm * BM + wr * 64 + fr, col0 = u.pn * BM + wc * 32 + 8 * fq;
#pragma unroll
        for (int ai = 0; ai < 2; ++ai)
#pragma unroll
            for (int mh = 0; mh < 2; ++mh) {
                u32x4 rv[2][2];
#pragma unroll
                for (int m = 0; m < 2; ++m)
#pragma unroll
                    for (int bj = 0; bj < 2; ++bj) rv[m][bj] = *(const u32x4*)(Rb + (size_t)(row0 + ai * HALF + (2 * mh + m) * 16) * 1024 + col0 + bj * HALF);
#pragma unroll
                for (int m = 0; m < 2; ++m)
#pragma unroll
                    for (int bj = 0; bj < 2; ++bj) { const u32x4 w = rv[m][bj];
                        acc[ai][bj][2 * mh + m][0] *= (f32x4){bflo(w.x), bfhi(w.x), bflo(w.y), bfhi(w.y)}; acc[ai][bj][2 * mh + m][1] *= (f32x4){bflo(w.z), bfhi(w.z), bflo(w.w), bfhi(w.w)}; }
                asm volatile("" ::: "memory");
            }
    }
    __device__ __forceinline__ void operator()(const f32x4 (&acc)[2][2][4][2], const Unit& u, int wr, int wc, int fr, int fq) const {
        asm volatile("" : "+v"(fr), "+v"(fq));
        const int row0 = u.pm * BM + wr * 64 + fr, col0 = u.pn * BM + wc * 32 + 8 * fq;
#pragma unroll
        for (int ai = 0; ai < 2; ++ai)
#pragma unroll
            for (int m = 0; m < 4; ++m) { const size_t off = (size_t)(row0 + ai * HALF + m * 16) * 1024 + col0;
#pragma unroll
                for (int bj = 0; bj < 2; ++bj) { const u32x4 w = *(const u32x4*)(Gb + off + bj * HALF);
                    const f32x4 a = acc[ai][bj][m][0] * (f32x4){bflo(w.x), bfhi(w.x), bflo(w.y), bfhi(w.y)}, b = acc[ai][bj][m][1] * (f32x4){bflo(w.z), bfhi(w.z), bflo(w.w), bfhi(w.w)};
                    *(u32x4*)(O + off + bj * HALF) = pack8(a, b); } }
    }
};
struct EpiY1 {
    static constexpr bool HAS_MID = false;
    const float* x; float* y;
    __device__ __forceinline__ void mid(f32x4 (&)[2][2][4][2], const Unit&, int, int, int, int) const {}
    __device__ __forceinline__ void operator()(const f32x4 (&acc)[2][2][4][2], const Unit& u, int wr, int wc, int fr, int fq) const {
        asm volatile("" : "+v"(fr), "+v"(fq));
        const int row0 = u.pm * BM + wr * 64 + fr, col0 = u.pn * BM + wc * 32 + 8 * fq;
#pragma unroll
        for (int ai = 0; ai < 2; ++ai)
#pragma unroll
            for (int m = 0; m < 4; ++m) { const size_t off = (size_t)(row0 + ai * HALF + m * 16) * 1024 + col0;
#pragma unroll
                for (int bj = 0; bj < 2; ++bj)
#pragma unroll
                    for (int n = 0; n < 2; ++n) { const f32x4 xv = *(const f32x4*)(x + off + bj * HALF + 4 * n); *(f32x4*)(y + off + bj * HALF + 4 * n) = xv * ALPHA + acc[ai][bj][m][n]; } }
    }
};
struct EpiGU {
    static constexpr bool HAS_MID = false;
    bf16_t* H;
    __device__ __forceinline__ void mid(f32x4 (&)[2][2][4][2], const Unit&, int, int, int, int) const {}
    __device__ __forceinline__ void operator()(const f32x4 (&acc)[2][2][4][2], const Unit& u, int wr, int wc, int fr, int fq) const {
        const int row0 = u.pm * BM + wr * 64 + fr, col0 = u.pn * 128 + wc * 32 + 8 * fq;
#pragma unroll
        for (int ai = 0; ai < 2; ++ai)
#pragma unroll
            for (int m = 0; m < 4; ++m) { f32x4 hv[2];
#pragma unroll
                for (int n = 0; n < 2; ++n)
#pragma unroll
                    for (int j = 0; j < 4; ++j) { const float g = acc[ai][0][m][n][j], up = acc[ai][1][m][n][j];
                        hv[n][j] = g * __builtin_amdgcn_rcpf(1.0f + __builtin_amdgcn_exp2f(-LOG2E * g)) * up; }
                *(u32x4*)(H + (size_t)(row0 + ai * HALF + m * 16) * 512 + col0) = pack8(hv[0], hv[1]); }
    }
};
struct EpiBf {
    static constexpr bool HAS_MID = false;
    bf16_t* O; int ldc;
    __device__ __forceinline__ void mid(f32x4 (&)[2][2][4][2], const Unit&, int, int, int, int) const {}
    __device__ __forceinline__ void operator()(const f32x4 (&acc)[2][2][4][2], const Unit& u, int wr, int wc, int fr, int fq) const {
        asm volatile("" : "+v"(fr), "+v"(fq));
        const int row0 = u.pm * BM + wr * 64 + fr, col0 = u.pn * BM + wc * 32 + 8 * fq;
#pragma unroll
        for (int ai = 0; ai < 2; ++ai)
#pragma unroll
            for (int m = 0; m < 4; ++m) { bf16_t* rowp = O + (size_t)(row0 + ai * HALF + m * 16) * ldc + col0;
#pragma unroll
                for (int bj = 0; bj < 2; ++bj) *(u32x4*)(rowp + bj * HALF) = pack8(acc[ai][bj][m][0], acc[ai][bj][m][1]); }
    }
};

template <class Epi, class Sched, bool ALIGN_EPI, bool GATHER>
__device__ __forceinline__ void gemm_phase(LAS unsigned char* lds, const int K, const Sched& S, const Epi& E) {
    const int tid = threadIdx.x, wid = __builtin_amdgcn_readfirstlane(tid >> 6), lane = tid & 63, wr = wid >> 2, wc = wid & 3, fr = lane & 15, fq = lane >> 4;
    const int nt = K / BK;
    int RA[2], CA[2];
    unsigned voffA[GATHER ? 4 : 2], voffB[2];
#pragma unroll
    for (int i = 0; i < 2; ++i) { int R, C; stage_rc(tid * 16 + i * 8192, R, C); RA[i] = R; CA[i] = C; const int Rb = (R & ~31) + perm32(R & 31);
        voffB[i] = (unsigned)(Rb * K + C) * 2u; if constexpr (!GATHER) voffA[i] = (unsigned)(R * K + C) * 2u; }
    const size_t kstep = (size_t)(BK * 2);
    const size_t hstep = (size_t)HALF * K * 2;
    const unsigned ldsw = (unsigned)wid * 1024u;
    const int aoff = lds_byte(wr * 64 + fr, fq * 8), boff = lds_byte(wc * 32 + fr, fq * 8);
#define PG8_SA(b, h) (((b) * 2 + (h)) * HTB)
#define PG8_SB(b, h) ((4 + (b) * 2 + (h)) * HTB)
#define PG8_STA(b, h, gbase) do { _Pragma("unroll") for (int _i = 0; _i < 2; ++_i) \
        __builtin_amdgcn_global_load_lds((const unsigned*)((gbase) + (GATHER ? (size_t)0 : (size_t)(h) * hstep) + voffA[GATHER ? (h) * 2 + _i : _i]), (LAS unsigned*)(lds + PG8_SA(b, h) + ldsw + _i * 8192), 16, 0, 0); } while (0)
#define PG8_STB(b, h, gbase) do { _Pragma("unroll") for (int _i = 0; _i < 2; ++_i) \
        __builtin_amdgcn_global_load_lds((const unsigned*)((gbase) + (size_t)(h) * hstep + voffB[_i]), (LAS unsigned*)(lds + PG8_SB(b, h) + ldsw + _i * 8192), 16, 0, 0); } while (0)
#define PG8_LDA(dst, b, h) do { _Pragma("unroll") for (int m = 0; m < 4; ++m) _Pragma("unroll") for (int k = 0; k < 2; ++k) dst[m][k] = *(const LAS bf16x8*)(lds + PG8_SA(b, h) + aoff + m * 2048 + k * 1024); } while (0)
#define PG8_LDB(dst, b, h) do { _Pragma("unroll") for (int n = 0; n < 2; ++n) _Pragma("unroll") for (int k = 0; k < 2; ++k) dst[n][k] = *(const LAS bf16x8*)(lds + PG8_SB(b, h) + boff + n * 2048 + k * 1024); } while (0)
#define PG8_MMA(ai, bj, At, Bt) do { __builtin_amdgcn_s_setprio(1); _Pragma("unroll") for (int m = 0; m < 4; ++m) _Pragma("unroll") for (int n = 0; n < 2; ++n) _Pragma("unroll") for (int k = 0; k < 2; ++k) \
        acc[ai][bj][m][n] = __builtin_amdgcn_mfma_f32_16x16x32_bf16(Bt[n][k], At[m][k], acc[ai][bj][m][n], 0, 0, 0); __builtin_amdgcn_s_setprio(0); } while (0)
#define PG8_WAIT_V(n) asm volatile("s_waitcnt vmcnt(" #n ")" ::: "memory")
#define PG8_WAIT_L(n) asm volatile("s_waitcnt lgkmcnt(" #n ")" ::: "memory")
#define PG8_BAR __builtin_amdgcn_s_barrier()
#define PG8_SCHED __builtin_amdgcn_sched_barrier(0)
#define PG8_GATHER(u) do { _Pragma("unroll") for (int _h = 0; _h < 2; ++_h) _Pragma("unroll") for (int _i = 0; _i < 2; ++_i) \
        voffA[GATHER ? _h * 2 + _i : 0] = (S.a_row(u, _h * HALF + RA[_i]) * (unsigned)K + (unsigned)CA[_i]) * 2u; } while (0)
    Unit cur, nxt; int ui = 0;
    if (!S.next(0, cur)) return;
    f32x4 acc[2][2][4][2];
#pragma unroll
    for (int a = 0; a < 2; ++a)
#pragma unroll
        for (int b = 0; b < 2; ++b)
#pragma unroll
            for (int m = 0; m < 4; ++m)
#pragma unroll
                for (int n = 0; n < 2; ++n) acc[a][b][m][n] = (f32x4){0.f, 0.f, 0.f, 0.f};
    bf16x8 At[4][2], B0[2][2], B1[2][2];
    const char* cA = S.a_base(cur); const char* cB = S.b_base(cur);
    if constexpr (GATHER) PG8_GATHER(cur);
    PG8_STB(0, 0, cB); PG8_STB(0, 1, cB); PG8_STA(0, 0, cA); PG8_STA(0, 1, cA);
    if (wr == 1) PG8_BAR;
    PG8_WAIT_V(2); PG8_BAR;
    PG8_STB(1, 0, cB + kstep); PG8_STA(1, 0, cA + kstep); PG8_STB(1, 1, cB + kstep);
    PG8_WAIT_V(6); PG8_BAR;
    for (;;) {
        const bool has_next = S.next(ui + 1, nxt);
        const char* nA = has_next ? S.a_base(nxt) : cA; const char* nB = has_next ? S.b_base(nxt) : cB;
        for (int t = 0; t < nt; t += 2) {
            const bool last = (t == nt - 2);
            const char* a1 = cA + (size_t)(t + 1) * kstep;
            const char* a2 = last ? nA : cA + (size_t)(t + 2) * kstep; const char* b2 = last ? nB : cB + (size_t)(t + 2) * kstep;
            const char* a3 = a2 + kstep; const char* b3 = b2 + kstep;
            if constexpr (Epi::HAS_MID) { if (t == nt / 2) E.mid(acc, cur, wr, wc, fr, fq); }
            PG8_LDB(B0, 0, 0); PG8_LDB(B1, 0, 1); PG8_SCHED; PG8_LDA(At, 0, 0); PG8_STA(1, 1, a1);
            if constexpr (GATHER) { if (last && has_next) PG8_GATHER(nxt); }
            PG8_WAIT_V(8); PG8_WAIT_L(0); PG8_BAR; PG8_MMA(0, 0, At, B0); PG8_MMA(0, 1, At, B1); PG8_BAR; PG8_SCHED;
            PG8_LDA(At, 0, 1); PG8_STB(0, 0, b2); PG8_STB(0, 1, b2); PG8_STA(0, 0, a2);
            PG8_WAIT_V(8); PG8_WAIT_L(0); PG8_BAR; PG8_MMA(1, 0, At, B0); PG8_MMA(1, 1, At, B1); PG8_BAR; PG8_SCHED;
            PG8_LDB(B0, 1, 0); PG8_LDB(B1, 1, 1); PG8_SCHED; PG8_LDA(At, 1, 0); PG8_STA(0, 1, a2);
            PG8_WAIT_V(8); PG8_WAIT_L(0); PG8_BAR; PG8_MMA(0, 0, At, B0); PG8_MMA(0, 1, At, B1); PG8_BAR; PG8_SCHED;
            PG8_LDA(At, 1, 1); PG8_STB(1, 0, b3); PG8_STB(1, 1, b3); PG8_STA(1, 0, a3);
            PG8_WAIT_V(8); PG8_WAIT_L(0); PG8_BAR; PG8_MMA(1, 0, At, B0); PG8_MMA(1, 1, At, B1); PG8_BAR; PG8_SCHED;
        }
        if constexpr (ALIGN_EPI) { if (wr == 0) PG8_BAR; }
        E(acc, cur, wr, wc, fr, fq);
        if (!has_next) break;
#pragma unroll
        for (int a = 0; a < 2; ++a)
#pragma unroll
            for (int b = 0; b < 2; ++b)
#pragma unroll
                for (int m = 0; m < 4; ++m)
#pragma unroll
                    for (int n = 0; n < 2; ++n) acc[a][b][m][n] = (f32x4){0.f, 0.f, 0.f, 0.f};
        cur = nxt; cA = nA; cB = nB; ++ui;
        if constexpr (ALIGN_EPI) { if (wr == 1) PG8_BAR; }
    }
    PG8_WAIT_V(0);
    if constexpr (!ALIGN_EPI) { if (wr == 0) PG8_BAR; }
    PG8_BAR;
#undef PG8_SA
#undef PG8_SB
#undef PG8_STA
#undef PG8_STB
#undef PG8_LDA
#undef PG8_LDB
#undef PG8_MMA
#undef PG8_WAIT_V
#undef PG8_WAIT_L
#undef PG8_BAR
#undef PG8_SCHED
#undef PG8_GATHER
}
}

namespace sba {
__device__ __forceinline__ int crow(int r, int hi) { return (r & 3) + 8 * (r >> 2) + 4 * hi; }
__device__ __forceinline__ s16x4 vtr(const LAS unsigned char* p) { return __builtin_bit_cast(s16x4, __builtin_amdgcn_ds_read_tr16_b64_v4i16((LAS s16x4*)p)); }

__device__ __forceinline__ void unit(const int bh, const int qb, const bf16_t* __restrict__ Q, const bf16_t* __restrict__ Kt, const bf16_t* __restrict__ V, bf16_t* __restrict__ O, LAS unsigned char* vl, const int lane) {
    const int r32 = lane & 31, hi = lane >> 5;
    const int b = bh >> 3, h = bh & 7;
    const size_t rowbase = (size_t)b * SEQ;
    const int q0 = qb * 32;
    bf16x8 qr[4];
    { const bf16_t* Qp = Q + (rowbase + q0 + r32) * 512 + h * 64 + hi * 8;
#pragma unroll
      for (int d0 = 0; d0 < 4; ++d0) qr[d0] = *(const bf16x8*)(Qp + d0 * 16); }
    f32x16 o0, o1;
#pragma unroll
    for (int r = 0; r < 16; ++r) { o0[r] = 0.f; o1[r] = 0.f; }
    float R = 0.f;
    const int tdiag = q0 >> 6;
    unsigned vpa = (unsigned)(uintptr_t)vl + ((lane >> 4) & 1) * 32 + (lane & 3) * 8 + (4 * hi + ((lane & 15) >> 2)) * 64; asm volatile("" : "+v"(vpa));
    const LAS unsigned char* vp = (const LAS unsigned char*)(uintptr_t)vpa;
    for (int t = tdiag; t >= 0; --t) {
        const int kv0 = t * 64;
        bf16x8 ka[4], kb[4];
        { const bf16_t* Kp = Kt + (rowbase + kv0 + r32) * 512 + h * 64 + hi * 8;
#pragma unroll
          for (int d0 = 0; d0 < 4; ++d0) { ka[d0] = *(const bf16x8*)(Kp + d0 * 16); kb[d0] = *(const bf16x8*)(Kp + 32 * 512 + d0 * 16); } }
        { const bf16_t* Vp = V + (rowbase + kv0 + (lane >> 2)) * 512 + h * 64 + (lane & 3) * 8;
#pragma unroll
          for (int p = 0; p < 8; ++p) __builtin_amdgcn_global_load_lds((const unsigned*)(Vp + (size_t)(16 * (p & 3)) * 512 + 32 * (p >> 2)), (LAS unsigned*)(vl + p * 1024), 16, 0, 0); }
        f32x16 p0, p1;
#pragma unroll
        for (int r = 0; r < 16; ++r) { p0[r] = 0.f; p1[r] = 0.f; }
#pragma unroll
        for (int d0 = 0; d0 < 4; ++d0) { p0 = __builtin_amdgcn_mfma_f32_32x32x16_bf16(ka[d0], qr[d0], p0, 0, 0, 0); p1 = __builtin_amdgcn_mfma_f32_32x32x16_bf16(kb[d0], qr[d0], p1, 0, 0, 0); }
        const int lim = (t == tdiag) ? (q0 - kv0) + r32 : 64;
        float sfx[32];
#pragma unroll
        for (int r = 0; r < 32; ++r) {
            const float y = (r < 16) ? p0[r & 15] : p1[r & 15];
            const int kvl = crow(r & 15, hi) + ((r < 16) ? 0 : 32);
            const float e = __builtin_amdgcn_exp2f(-fabsf(y));
            const float l = fmaxf(y, 0.f) + __builtin_amdgcn_logf(1.0f + e);
            sfx[r] = (kvl < lim) ? l : 0.f;
        }
#pragma unroll
        for (int g = 0; g < 8; ++g) { sfx[4 * g + 2] += sfx[4 * g + 3]; sfx[4 * g + 1] += sfx[4 * g + 2]; sfx[4 * g] += sfx[4 * g + 1]; }
        float off = R;
#pragma unroll
        for (int g = 7; g >= 0; --g) {
            const float tg = sfx[4 * g];
            const unsigned ti = __float_as_uint(tg); auto rr = __builtin_amdgcn_permlane32_swap(ti, ti, false, false);
            const float ptg = __uint_as_float(hi ? rr[0] : rr[1]);
            const float mine = off + (hi ? 0.f : ptg);
#pragma unroll
            for (int j = 0; j < 4; ++j) sfx[4 * g + j] += mine;
            off += tg + ptg;
        }
        R = off;
        u32x4 pw[4];
#pragma unroll
        for (int s = 0; s < 4; ++s)
#pragma unroll
            for (int i = 0; i < 4; ++i) {
                float w2[2];
#pragma unroll
                for (int k = 0; k < 2; ++k) { const int r = 8 * s + 2 * i + k;
                    const float y = (r < 16) ? p0[r & 15] : p1[r & 15];
                    const int kvl = crow(r & 15, hi) + ((r < 16) ? 0 : 32);
                    const float w = __builtin_amdgcn_exp2f(y - sfx[r]);
                    w2[k] = (kvl < lim) ? w : 0.f; }
                pw[s][i] = cvtpk(w2[0], w2[1]); }
        asm volatile("s_waitcnt vmcnt(0)" ::: "memory");
#pragma unroll
        for (int s = 0; s < 4; ++s) {
            const s16x4 l0 = vtr(vp + s * 1024), h0 = vtr(vp + s * 1024 + 512), l1 = vtr(vp + 4096 + s * 1024), h1 = vtr(vp + 4096 + s * 1024 + 512);
            const bf16x8 v0 = (bf16x8){l0[0], l0[1], l0[2], l0[3], h0[0], h0[1], h0[2], h0[3]}, v1 = (bf16x8){l1[0], l1[1], l1[2], l1[3], h1[0], h1[1], h1[2], h1[3]};
            const bf16x8 pa = __builtin_bit_cast(bf16x8, pw[s]);
            o0 = __builtin_amdgcn_mfma_f32_32x32x16_bf16(pa, v0, o0, 0, 0, 0);
            o1 = __builtin_amdgcn_mfma_f32_32x32x16_bf16(pa, v1, o1, 0, 0, 0);
        }
        if (__all(R >= R_STOP)) break;
    }
    LAS bf16_t* stg = (LAS bf16_t*)vl;
#pragma unroll
    for (int r = 0; r < 16; ++r) { const int orow = crow(r, hi);
        stg[orow * 64 + r32] = (bf16_t)(cvtpk(o0[r], 0.f) & 0xffffu); stg[orow * 64 + 32 + r32] = (bf16_t)(cvtpk(o1[r], 0.f) & 0xffffu); }
    bf16_t* Ow = O + (rowbase + q0) * 1024 + h * 64;
#pragma unroll
    for (int i = 0; i < 4; ++i) { const int row = i * 8 + (lane >> 3), ch = lane & 7; const u32x4 v = *(const LAS u32x4*)(stg + row * 64 + ch * 8); *(u32x4*)(Ow + (size_t)row * 1024 + ch * 8) = v; }
}
}

#define XB_TMO      128
#define XB_XCNT(j)  (256  + 64 * (j))
#define XB_XSUB(j)  (1280 + 64 * (j))
#define XB_XGEN(j)  (2304 + 64 * (j))
#define XB_TOP      3328
#define XB_TOPGEN   3392
#define XCD_BAR_WORDS 3456
#define XB_SPIN_CAP (1u << 18)
__device__ __forceinline__ unsigned xb_ld(unsigned* p)              { return __hip_atomic_load(p, __ATOMIC_RELAXED, __HIP_MEMORY_SCOPE_AGENT); }
__device__ __forceinline__ unsigned xb_add(unsigned* p, unsigned v) { return __hip_atomic_fetch_add(p, v, __ATOMIC_RELAXED, __HIP_MEMORY_SCOPE_AGENT); }
__device__ __forceinline__ unsigned xb_xcc_id() { return (unsigned)__builtin_amdgcn_s_getreg((3 << 11) | 20) & 0xFu; }
#define XB_SPIN(cond, bar) do { unsigned _sp = 0; while (cond) { __builtin_amdgcn_s_sleep(1); \
    if ((++_sp & 255u) == 0u) { if (xb_ld(&(bar)[XB_TMO])) break; if (_sp > XB_SPIN_CAP) { atomicAdd(&(bar)[XB_TMO], 1u); break; } } } } while (0)
struct XcdBarrier { unsigned* bar; unsigned x; volatile LAS unsigned* st; };
__device__ __forceinline__ XcdBarrier xcd_barrier_post(unsigned* bar, volatile LAS unsigned* st) {
    XcdBarrier b; b.bar = bar; b.x = xb_xcc_id(); b.st = st;
    if (threadIdx.x == 0) (void)xb_add(&bar[XB_XCNT(b.x)], 1u);
    return b;
}
__device__ __forceinline__ void xcd_barrier_complete(unsigned* bar, unsigned x, unsigned& nloc, unsigned& nx) {
    const unsigned G = gridDim.x * gridDim.y * gridDim.z;
    unsigned sum, cnt, mine, sp = 0u;
    for (;;) {
        sum = 0u; cnt = 0u; mine = 0u;
#pragma unroll
        for (unsigned j = 0; j < 16; ++j) { const unsigned c = xb_ld(&bar[XB_XCNT(j)]); sum += c; cnt += (c > 0u) ? 1u : 0u; mine = (j == x) ? c : mine; }
        if (sum == G) break;
        __builtin_amdgcn_s_sleep(1);
        if ((++sp & 255u) == 0u) { if (xb_ld(&bar[XB_TMO])) break; if (sp > XB_SPIN_CAP) { atomicAdd(&bar[XB_TMO], 1u); break; } }
    }
    nloc = mine > 0u ? mine : 1u; nx = cnt > 0u ? cnt : 1u;
}
__device__ __forceinline__ void xcd_barrier(const XcdBarrier& b) {
    asm volatile("s_waitcnt vmcnt(0)" ::: "memory");
    __syncthreads();
    if (threadIdx.x == 0) {
        unsigned* bar = b.bar;
        __builtin_amdgcn_s_waitcnt(0);
        unsigned nloc = b.st[0], nx = b.st[1];
        if (nloc == 0u) { xcd_barrier_complete(bar, b.x, nloc, nx); b.st[0] = nloc; b.st[1] = nx; }
        const unsigned old = xb_add(&bar[XB_XSUB(b.x)], 1u);
        const unsigned gen = old / nloc;
        if (old + 1u == (gen + 1u) * nloc) {
            __builtin_amdgcn_fence(__ATOMIC_RELEASE, "agent");
            asm volatile("s_waitcnt vmcnt(0)" ::: "memory");
            const unsigned og = xb_add(&bar[XB_TOP], 1u);
            const unsigned tg = og / nx;
            if (og + 1u == (tg + 1u) * nx) xb_add(&bar[XB_TOPGEN], 1u);
            else XB_SPIN(xb_ld(&bar[XB_TOPGEN]) == tg, bar);
            __builtin_amdgcn_fence(__ATOMIC_ACQUIRE, "agent");
            xb_add(&bar[XB_XGEN(b.x)], 1u);
            asm volatile("s_waitcnt vmcnt(0)" ::: "memory");
        } else {
            XB_SPIN(xb_ld(&bar[XB_XGEN(b.x)]) == gen, bar);
            __builtin_amdgcn_fence(__ATOMIC_ACQUIRE, "agent");
            asm volatile("s_waitcnt vmcnt(0)" ::: "memory");
        }
    }
    __syncthreads();
}

__device__ __forceinline__ void tr_item(const float* __restrict__ W, const int N, const int k0, const int n0, bf16_t* __restrict__ dst, const int ldk, LAS float* scr, const int lane) {
    f32x4 v[16];
#pragma unroll
    for (int i = 0; i < 16; ++i) v[i] = *(const f32x4*)(W + (size_t)(k0 + 4 * i + (lane >> 4)) * N + n0 + (lane & 15) * 4);
#pragma unroll
    for (int i = 0; i < 16; ++i) { const int k = 4 * i + (lane >> 4), c = (k >> 3) & 7, nn = (lane & 15) * 4; *(LAS f32x4*)(scr + k * 64 + (nn ^ (c << 2))) = v[i]; }
    asm volatile("s_waitcnt lgkmcnt(0)" ::: "memory");
    const int c = lane & 7;
#pragma unroll
    for (int j = 0; j < 8; ++j) { const int n = (lane >> 3) + 8 * j; const LAS float* s = scr + (8 * c) * 64 + (n ^ (c << 2));
        u32x4 o; o.x = cvtpk(s[0], s[64]); o.y = cvtpk(s[128], s[192]); o.z = cvtpk(s[256], s[320]); o.w = cvtpk(s[384], s[448]);
        *(u32x4*)(dst + (size_t)n * ldk + 8 * c) = o; }
    asm volatile("s_waitcnt lgkmcnt(0)" ::: "memory");
}

struct Args { const float* in[18]; float* out; unsigned char* ws; int ph_lo, ph_hi; };

constexpr int NPHASE = 9;
constexpr int NWAVES = 8;

__global__ void __launch_bounds__(NWAVES * 64, 2) fwd_kernel(Args args) {
    extern __shared__ __attribute__((aligned(16))) unsigned char lds_raw[];
    LAS unsigned char* lds = (LAS unsigned char*)lds_raw;
    volatile LAS unsigned* MISC = (volatile LAS unsigned*)(lds + MISC_OFF);
    const int tid = threadIdx.x, lane = tid & 63, wave = __builtin_amdgcn_readfirstlane(tid >> 6);
    const int G = gridDim.x, bx = blockIdx.x;
    const int vcu = (G % 8 == 0) ? (bx % 8) * (G / 8) + bx / 8 : bx;
    const int gw = vcu * NWAVES + wave, NGW = G * NWAVES;
    unsigned char* ws = args.ws;
    unsigned* ctl = (unsigned*)(ws + WS_CTL);
    const float* x = args.in[0];
    float* out = args.out;
    bf16_t* Win_t = (bf16_t*)(ws + WS_WIN); bf16_t* Wab_t = (bf16_t*)(ws + WS_WAB); bf16_t* Wout_t = (bf16_t*)(ws + WS_WOUT);
    bf16_t* Wgu_t = (bf16_t*)(ws + WS_WGU); bf16_t* Wd_t = (bf16_t*)(ws + WS_WD);
    float* rtab = (float*)(ws + WS_RTAB);
    bf16_t* RA = (bf16_t*)(ws + WS_RA);
    bf16_t* P6 = (bf16_t*)(ws + WS_P6);
    bf16_t* Rb = (bf16_t*)(ws + WS_R); bf16_t* Gb = (bf16_t*)(ws + WS_GB);
    bf16_t* MG = (bf16_t*)(ws + WS_MERGED); bf16_t* Hb = (bf16_t*)(ws + WS_H); bf16_t* Yb = (bf16_t*)(ws + WS_Y);
    int* slot_tok = (int*)(ws + WS_SLOT); int* RT = (int*)(ws + WS_RT);
    unsigned* cnt = ctl + CW_CNT;

    for (int u = tid; u < (LDS_BYTES - MISC_OFF) / 4; u += NWAVES * 64) ((LAS unsigned*)(lds + MISC_OFF))[u] = 0u;
    __syncthreads();
    XcdBarrier bar; bar.bar = ctl + CW_BAR; bar.x = 0; bar.st = nullptr;
    if (MK_N_LAUNCHES == 1) bar = xcd_barrier_post(ctl + CW_BAR, MISC + 8);
    const int lo = args.ph_lo, hi = args.ph_hi;
#ifndef PHMASK
#define PHMASK 0x1FF
#endif
#define IN(k) (((PHMASK >> (k)) & 1) && lo <= (k) && (k) < hi)
#define SEAM(k) do { if (IN(k) && IN((k) + 1)) xcd_barrier(bar); } while (0)

    if (IN(0)) {
        LAS float* scr = (LAS float*)(lds + wave * 16384);
        constexpr int I_IN = 16 * 80, I_A = 8 * 16, I_B = 8 * 16, I_O = 16 * 16, I_G = 32 * 16 * 8, I_U = I_G, I_D = 32 * 8 * 16;
        constexpr int NITEMS = I_IN + I_A + I_B + I_O + I_G + I_U + I_D;
        for (int it = gw; it < NITEMS; it += NGW) {
            int r = it;
            if (r < I_IN) { const int kb = r / 80, nb = r % 80, n0 = nb * 64; int dr;
                if (n0 < 3072) dr = n0; else { const int j = n0 - 3072, isb = j >> 10, jj = j & 1023; dr = 3072 + (jj >> 7) * 256 + isb * 128 + (jj & 127); }
                tr_item(args.in[1], PROJ, kb * 64, n0, Win_t + (size_t)dr * 1024 + kb * 64, 1024, scr, lane); continue; } r -= I_IN;
            if (r < I_A) { const int kb = r / 16, nb = r % 16; tr_item(args.in[4], 1024, kb * 64, nb * 64, Wab_t + (size_t)(nb * 64) * 1024 + kb * 64, 1024, scr, lane); continue; } r -= I_A;
            if (r < I_B) { const int kb = r / 16, nb = r % 16; tr_item(args.in[5], 1024, kb * 64, nb * 64, Wab_t + (size_t)(nb * 64) * 1024 + 512 + kb * 64, 1024, scr, lane); continue; } r -= I_B;
            if (r < I_O) { const int kb = r / 16, nb = r % 16; tr_item(args.in[6], 1024, kb * 64, nb * 64, Wout_t + (size_t)(nb * 64) * 1024 + kb * 64, 1024, scr, lane); continue; } r -= I_O;
            if (r < I_G + I_U) { const int up = r >= I_G; if (up) r -= I_G; const int e = r / 128, q = r % 128, kb = q / 8, nb = q % 8, n0 = nb * 64;
                const int dr = (n0 >> 7) * 256 + up * 128 + (n0 & 127);
                tr_item(args.in[up ? 14 : 13] + (size_t)e * 1024 * 512, 512, kb * 64, n0, Wgu_t + (size_t)e * 1024 * 1024 + (size_t)dr * 1024 + kb * 64, 1024, scr, lane); continue; } r -= I_G + I_U;
            { const int e = r / 128, q = r % 128, kb = q / 16, nb = q % 16;
              tr_item(args.in[15] + (size_t)e * 512 * 1024, 1024, kb * 64, nb * 64, Wd_t + (size_t)e * 1024 * 512 + (size_t)(nb * 64) * 512 + kb * 64, 512, scr, lane); }
        }
        { const size_t n8 = (size_t)T * D / 8;
          for (size_t i = (size_t)gw * 64 + lane; i < n8; i += (size_t)NGW * 64) { const f32x4 a = *(const f32x4*)(x + i * 8), b = *(const f32x4*)(x + i * 8 + 4); *(u32x4*)(RA + i * 8) = pg8::pack8(a, b); } }
        for (int i = gw * 64 + lane; i < 36 * 1024; i += NGW * 64) { const int c = i >> 10, k = i & 1023; rtab[i] = (c < 4) ? args.in[9][k * 4 + c] : args.in[11][k * 32 + (c - 4)]; }
    }
    SEAM(0);

    if (IN(1)) {
        pg8::DenseOrder S; S.init(RA, Win_t, T, PROJ, D, G, bx);
        pg8::EpiProj E{P6, Rb, Gb, args.in[2]};
        pg8::gemm_phase<pg8::EpiProj, pg8::DenseOrder, true, false>(lds, D, S, E);
    }
    SEAM(1);

    if (IN(2)) {
        const bf16_t* CB = P6 + (size_t)3 * T * 512; const bf16_t* CC = P6 + (size_t)4 * T * 512; const bf16_t* CH = P6 + (size_t)5 * T * 512;
        const float* cw = args.in[3];
        for (int item = gw; item < T / 16; item += NGW) {
            const int t0 = item * 16, c0 = lane * 8;
            float w0[8], w1[8], w2[8], um2[8], um1[8];
#pragma unroll
            for (int j = 0; j < 8; ++j) { w0[j] = cw[c0 + j]; w1[j] = cw[512 + c0 + j]; w2[j] = cw[1024 + c0 + j]; um2[j] = 0.f; um1[j] = 0.f; }
            if ((t0 & (SEQ - 1)) != 0) {
                const u32x4 a2 = *(const u32x4*)(CC + (size_t)(t0 - 2) * 512 + c0), b2 = *(const u32x4*)(CH + (size_t)(t0 - 2) * 512 + c0);
                const u32x4 a1 = *(const u32x4*)(CC + (size_t)(t0 - 1) * 512 + c0), b1 = *(const u32x4*)(CH + (size_t)(t0 - 1) * 512 + c0);
#pragma unroll
                for (int j = 0; j < 4; ++j) { um2[2 * j] = bflo(a2[j]) * bflo(b2[j]); um2[2 * j + 1] = bfhi(a2[j]) * bfhi(b2[j]); um1[2 * j] = bflo(a1[j]) * bflo(b1[j]); um1[2 * j + 1] = bfhi(a1[j]) * bfhi(b1[j]); }
            }
#pragma unroll 4
            for (int i = 0; i < 16; ++i) {
                const size_t off = (size_t)(t0 + i) * 512 + c0;
                const u32x4 cc = *(const u32x4*)(CC + off), ch = *(const u32x4*)(CH + off), cb = *(const u32x4*)(CB + off);
                float u[8], yv[8];
#pragma unroll
                for (int j = 0; j < 4; ++j) { u[2 * j] = bflo(cc[j]) * bflo(ch[j]); u[2 * j + 1] = bfhi(cc[j]) * bfhi(ch[j]); }
#pragma unroll
                for (int j = 0; j < 8; ++j) { yv[j] = w0[j] * um2[j] + w1[j] * um1[j] + w2[j] * u[j]; um2[j] = um1[j]; um1[j] = u[j]; }
                u32x4 o;
#pragma unroll
                for (int j = 0; j < 4; ++j) o[j] = cvtpk(bflo(cb[j]) * yv[2 * j], bfhi(cb[j]) * yv[2 * j + 1]);
                *(u32x4*)(RA + (size_t)(t0 + i) * 1024 + 512 + c0) = o;
            }
        }
        LAS unsigned char* vl = lds + wave * 8192;
        for (int un = gw; un < 32 * 256; un += NGW) sba::unit(un >> 8, un & 255, P6, P6 + (size_t)T * 512, P6 + (size_t)2 * T * 512, RA, vl, lane);
    }
    SEAM(2);

    if (IN(3)) {
        pg8::DenseOrder S; S.init(RA, Wab_t, T, D, D, G, bx);
        pg8::EpiMerged E{Rb, Gb, MG};
        pg8::gemm_phase<pg8::EpiMerged, pg8::DenseOrder, true, false>(lds, D, S, E);
    }
    SEAM(3);

    if (IN(4)) {
        pg8::DenseOrder S; S.init(MG, Wout_t, T, D, D, G, bx);
        pg8::EpiY1 E{x, out};
        pg8::gemm_phase<pg8::EpiY1, pg8::DenseOrder, true, false>(lds, D, S, E);
    }
    SEAM(4);

    if (IN(5)) {
        LAS float* tab = (LAS float*)lds;
        for (int i = tid * 4; i < 36 * 1024; i += NWAVES * 64 * 4) *(LAS f32x4*)(tab + i) = *(const f32x4*)(rtab + i);
        __syncthreads();
        const float* g1 = args.in[7]; const float* b1 = args.in[8];
        const float* brg = args.in[10]; const float* bre = args.in[12];
        int myE = 0, myTok = 0; float myW = 0.f;
        const float rbias = (lane < 4) ? brg[lane] : (lane < 36) ? bre[lane - 4] : 0.f;
        for (int base = gw * 16; base < T; base += NGW * 16) {
            for (int i = 0; i < 16; ++i) {
                const int m = base + i;
                float* yr = out + (size_t)m * D + lane * 4;
                f32x4 v[4]; float s = 0.f;
#pragma unroll
                for (int j = 0; j < 4; ++j) { v[j] = *(const f32x4*)(yr + 256 * j); s += (v[j].x + v[j].y) + (v[j].z + v[j].w); }
                const float mean = wave_sum(s) * (1.f / D); float s2 = 0.f;
#pragma unroll
                for (int j = 0; j < 4; ++j) { v[j] = v[j] - mean; s2 += (v[j].x * v[j].x + v[j].y * v[j].y) + (v[j].z * v[j].z + v[j].w * v[j].w); }
                const float rstd = 1.f / sqrtf(wave_sum(s2) * (1.f / D) + LN_EPS);
#pragma unroll
                for (int j = 0; j < 4; ++j) { const f32x4 gg = *(const f32x4*)(g1 + lane * 4 + 256 * j), bb = *(const f32x4*)(b1 + lane * 4 + 256 * j);
                    v[j] = v[j] * rstd * gg + bb; *(f32x4*)(yr + 256 * j) = v[j];
                    u32x2 pk; pk.x = cvtpk(v[j].x, v[j].y); pk.y = cvtpk(v[j].z, v[j].w); *(u32x2*)(RA + (size_t)m * D + lane * 4 + 256 * j) = pk; }
                float lgv = 0.f;
#pragma unroll 2
                for (int c = 0; c < 36; ++c) { f32x2 a2 = {0.f, 0.f};
#pragma unroll
                    for (int j = 0; j < 4; ++j) { const f32x4 w = *(const LAS f32x4*)(tab + c * 1024 + 256 * j + lane * 4); a2 += (f32x2){v[j].x, v[j].y} * (f32x2){w.x, w.y}; a2 += (f32x2){v[j].z, v[j].w} * (f32x2){w.z, w.w}; }
                    const float tot = wave_sum_u(a2.x + a2.y);
                    lgv = (lane == c) ? tot : lgv; }
                lgv += rbias;
                float gl[4];
#pragma unroll
                for (int c = 0; c < 4; ++c) gl[c] = __builtin_bit_cast(float, __builtin_amdgcn_readlane(__builtin_bit_cast(int, lgv), c));
                int gi = 0; float gm = gl[0];
#pragma unroll
                for (int c = 1; c < 4; ++c) if (gl[c] > gm) { gm = gl[c]; gi = c; }
                float den = 0.f;
#pragma unroll
                for (int c = 0; c < 4; ++c) den += __expf(gl[c] - gm);
                const float gp = 1.0f / den;
                gi = __builtin_amdgcn_readfirstlane(gi);
                float el[8];
#pragma unroll
                for (int j = 0; j < 8; ++j) el[j] = __builtin_bit_cast(float, __builtin_amdgcn_readlane(__builtin_bit_cast(int, lgv), 4 + gi * 8 + j));
                int i1 = 0; float m1 = el[0];
#pragma unroll
                for (int j = 1; j < 8; ++j) if (el[j] > m1) { m1 = el[j]; i1 = j; }
                int i2 = -1; float m2 = -INFINITY;
#pragma unroll
                for (int j = 0; j < 8; ++j) if (j != i1 && el[j] > m2) { m2 = el[j]; i2 = j; }
                const float ex = __expf(m2 - m1), w1 = 1.0f / (1.0f + ex), w2 = ex * w1;
                if (lane == 2 * i) { myE = gi * 8 + i1; myW = gp * w1; myTok = m; }
                if (lane == 2 * i + 1) { myE = gi * 8 + i2; myW = gp * w2; myTok = m; }
            }
            if (lane < 32) {
                const int rank = (int)__hip_atomic_fetch_add(cnt + myE, 1u, __ATOMIC_RELAXED, __HIP_MEMORY_SCOPE_AGENT);
                slot_tok[(size_t)myE * T + rank] = myTok;
                int* rt = RT + ((size_t)myTok * 2 + (lane & 1)) * 4; rt[0] = myE; rt[1] = rank; rt[2] = __float_as_int(myW);
            }
        }
        __syncthreads();
    }
    SEAM(5);

    if (IN(6) || IN(7) || IN(8)) {
        if (tid == 0) { int acc_t = 0;
            for (int e = 0; e < NEXP; ++e) { const int c = (int)__hip_atomic_load(cnt + e, __ATOMIC_RELAXED, __HIP_MEMORY_SCOPE_AGENT); MISC[64 + e] = (unsigned)acc_t; MISC[128 + e] = (unsigned)c; acc_t += (c + 255) >> 8; }
            MISC[64 + NEXP] = (unsigned)acc_t; }
        __syncthreads();
    }
    const LAS int* tb = (const LAS int*)(lds + MISC_OFF + 64 * 4); const LAS int* cntl = (const LAS int*)(lds + MISC_OFF + 128 * 4);

    if (IN(6)) {
        pg8::MoeOrder S{(const char*)RA, (const char*)Wgu_t, D, (size_t)1024 * 1024 * 2, G, vcu, true, tb, cntl, slot_tok};
        pg8::EpiGU E{Hb};
        pg8::gemm_phase<pg8::EpiGU, pg8::MoeOrder, true, true>(lds, D, S, E);
    }
    SEAM(6);

    if (IN(7)) {
        pg8::MoeOrder S{(const char*)Hb, (const char*)Wd_t, DEXP, (size_t)1024 * 512 * 2, G, vcu, false, tb, cntl, slot_tok};
        pg8::EpiBf E{Yb, 1024};
        pg8::gemm_phase<pg8::EpiBf, pg8::MoeOrder, true, false>(lds, DEXP, S, E);
    }
    SEAM(7);

    if (IN(8)) {
        const float* g2 = args.in[16]; const float* b2 = args.in[17];
        for (int m = gw; m < T; m += NGW) {
            const int* rt = RT + (size_t)m * 8;
            const int e0 = rt[0], r0 = rt[1], e1 = rt[4], r1 = rt[5]; const float w0 = __int_as_float(rt[2]), w1 = __int_as_float(rt[6]);
            const size_t s0 = (size_t)tb[e0] * 256 + r0, s1 = (size_t)tb[e1] * 256 + r1;
            float* hr = out + (size_t)m * D + lane * 4;
            const bf16_t* y0 = Yb + s0 * 1024 + lane * 4; const bf16_t* y1 = Yb + s1 * 1024 + lane * 4;
            f32x4 v[4]; float s = 0.f;
#pragma unroll
            for (int j = 0; j < 4; ++j) { const f32x4 hv = *(const f32x4*)(hr + 256 * j); const u32x2 a = *(const u32x2*)(y0 + 256 * j), b = *(const u32x2*)(y1 + 256 * j);
                v[j].x = ALPHA * hv.x + (w0 * bflo(a.x) + w1 * bflo(b.x)); v[j].y = ALPHA * hv.y + (w0 * bfhi(a.x) + w1 * bfhi(b.x));
                v[j].z = ALPHA * hv.z + (w0 * bflo(a.y) + w1 * bflo(b.y)); v[j].w = ALPHA * hv.w + (w0 * bfhi(a.y) + w1 * bfhi(b.y));
                s += (v[j].x + v[j].y) + (v[j].z + v[j].w); }
            const float mean = wave_sum(s) * (1.f / D); float s2 = 0.f;
#pragma unroll
            for (int j = 0; j < 4; ++j) { v[j] = v[j] - mean; s2 += (v[j].x * v[j].x + v[j].y * v[j].y) + (v[j].z * v[j].z + v[j].w * v[j].w); }
            const float rstd = 1.f / sqrtf(wave_sum(s2) * (1.f / D) + LN_EPS);
#pragma unroll
            for (int j = 0; j < 4; ++j) { const f32x4 gg = *(const f32x4*)(g2 + lane * 4 + 256 * j), bb = *(const f32x4*)(b2 + lane * 4 + 256 * j); *(f32x4*)(hr + 256 * j) = v[j] * rstd * gg + bb; }
        }
    }
#undef IN
#undef SEAM
}

extern "C" void kernel_launch(void* const* d_in, const int* in_sizes, int n_in, void* d_out, int out_size, void* d_ws, size_t ws_size, hipStream_t stream) {
    static int grid = 0;
    if (grid == 0) {
        if (n_in != 18 || in_sizes[0] != T * D || out_size != T * D || ws_size < WS_END) { fprintf(stderr, "kernel_launch: unexpected shapes / workspace (n_in %d, ws %zu < %zu); nothing launched\n", n_in, ws_size, (size_t)WS_END); grid = -1; return; }
        int dev = 0, cus = 0, per_cu = 0;
        if (hipGetDevice(&dev) != hipSuccess || hipDeviceGetAttribute(&cus, hipDeviceAttributeMultiprocessorCount, dev) != hipSuccess) { grid = -1; return; }
        if (hipFuncSetAttribute((const void*)fwd_kernel, hipFuncAttributeMaxDynamicSharedMemorySize, LDS_BYTES) != hipSuccess) { fprintf(stderr, "kernel_launch: hipFuncSetAttribute failed\n"); grid = -1; return; }
        if (hipOccupancyMaxActiveBlocksPerMultiprocessor(&per_cu, (const void*)fwd_kernel, NWAVES * 64, LDS_BYTES) != hipSuccess || per_cu < 1) { fprintf(stderr, "kernel_launch: occupancy query reports %d workgroups per CU; nothing launched\n", per_cu); (void)hipGetLastError(); grid = -1; return; }
        grid = cus;
    }
    if (grid < 0) return;
    (void)hipMemsetAsync((char*)d_ws + WS_CTL, 0, CTL_ZERO_BYTES, stream);
    Args a{};
    for (int i = 0; i < 18; ++i) a.in[i] = (const float*)d_in[i];
    a.out = (float*)d_out; a.ws = (unsigned char*)d_ws;
#if MK_N_LAUNCHES == 1
    a.ph_lo = 0; a.ph_hi = NPHASE;
    hipLaunchKernelGGL(fwd_kernel, dim3(grid), dim3(NWAVES * 64), LDS_BYTES, stream, a);
#else
    for (int p = 0; p < NPHASE; ++p) { a.ph_lo = p; a.ph_hi = p + 1; hipLaunchKernelGGL(fwd_kernel, dim3(grid), dim3(NWAVES * 64), LDS_BYTES, stream, a); }
#endif
}
```
